# Optimizing an MI355X kernel written in HIP

```python
import math
import jax, jax.numpy as jnp
from jax import lax
import numpy as np

D_MODEL = 1024
BATCH = 4
SEQ = 8192
DEPTH = 1
DEC_BATCH = 128
DEC_SEQ = 8
PAST_LEN = 16384
PAGE_SIZE = 128

N_HEADS = 8
HEAD_DIM = 64
N_KV_HEADS = 2
GROUP = N_HEADS // N_KV_HEADS
ATTN_WIDTH = N_HEADS * HEAD_DIM
KV_WIDTH = N_KV_HEADS * HEAD_DIM
WINDOW = 128
BLOCK = WINDOW
POOL_WIDTH = D_MODEL // 2
POOL_WINDOWS = (2, 4, 8, 16)
N_POOL_GROUPS = len(POOL_WINDOWS)
POOL_GROUP_WIDTH = POOL_WIDTH // N_POOL_GROUPS
POOL_STATE = max(POOL_WINDOWS) - 1
D_FF = 4 * D_MODEL
N_BUCKETS = 32
MAX_DISTANCE = 128
RMS_EPS = 1e-6
NEG_INF = -1e30
IN_WIDTH = ATTN_WIDTH + 2 * KV_WIDTH + POOL_WIDTH + 2 * D_MODEL
SPLITS = (ATTN_WIDTH, ATTN_WIDTH + KV_WIDTH, ATTN_WIDTH + 2 * KV_WIDTH,
          ATTN_WIDTH + 2 * KV_WIDTH + POOL_WIDTH,
          ATTN_WIDTH + 2 * KV_WIDTH + POOL_WIDTH + D_MODEL)

kernel_name = "hybrid_swa_sink_pool_gated_decode_step"


def rms_norm(x, g):
    xf = x.astype(jnp.float32)
    y = xf * lax.rsqrt(jnp.mean(xf * xf, axis=-1, keepdims=True) + RMS_EPS)
    return (y * g.astype(jnp.float32)).astype(x.dtype)


def rel_bucket(dist):
    d = jnp.maximum(dist, 0)
    max_exact = N_BUCKETS // 2
    large = max_exact + (jnp.log(jnp.maximum(d, 1).astype(jnp.float32) / max_exact)
                         / math.log(MAX_DISTANCE / max_exact)
                         * (N_BUCKETS - max_exact)).astype(jnp.int32)
    large = jnp.minimum(large, N_BUCKETS - 1)
    return jnp.where(d < max_exact, d, large)


def rel_bias(dist, table):
    b = table[rel_bucket(dist)]
    b = jnp.transpose(b, (2, 0, 1)).astype(jnp.float32)
    return b.reshape(N_KV_HEADS, GROUP, dist.shape[0], dist.shape[1])


def window_attention(q, k, v, valid, bias, sinks):
    s = jnp.einsum('bnqkgd,bnskd->bnkgqs', q, k,
                   preferred_element_type=jnp.float32) * (HEAD_DIM ** -0.5) + bias
    s = jnp.where(valid[None, :, None, None], s, NEG_INF)
    sink = sinks.astype(jnp.float32).reshape(1, 1, N_KV_HEADS, GROUP, 1, 1)
    m = jnp.maximum(jnp.max(s, axis=-1, keepdims=True), sink)
    p = jnp.exp(s - m)
    denom = jnp.sum(p, axis=-1, keepdims=True) + jnp.exp(sink - m)
    p = (p / denom).astype(v.dtype)
    return jnp.einsum('bnkgqs,bnskd->bnqkgd', p, v)


def pool_mix(ext, start_pos, w_grp, scale):
    B = ext.shape[0]
    T = ext.shape[1] - POOL_STATE
    cs = jnp.cumsum(jnp.pad(ext.astype(jnp.float32), ((0, 0), (1, 0), (0, 0))), axis=1)
    hi = cs[:, POOL_STATE + 1:]
    pos = start_pos + jnp.arange(T)
    parts = []
    for g, w in enumerate(POOL_WINDOWS):
        c = slice(g * POOL_GROUP_WIDTH, (g + 1) * POOL_GROUP_WIDTH)
        lo = cs[:, POOL_STATE + 1 - w:POOL_STATE + 1 - w + T, c]
        cnt = jnp.minimum(pos + 1, w).astype(jnp.float32)[None, :, None]
        parts.append((hi[..., c] - lo) / cnt)
    z = jnp.concatenate(parts, axis=-1) - ext[:, POOL_STATE:].astype(jnp.float32)
    z = z.astype(ext.dtype).reshape(B, T, N_POOL_GROUPS, POOL_GROUP_WIDTH)
    z = jnp.einsum('btgc,gcd->btgd', z, w_grp).reshape(B, T, POOL_WIDTH)
    return z * scale


def project_in(x, g_pre, w_in, b_in):
    u = rms_norm(x, g_pre) @ w_in + b_in
    return jnp.split(u, SPLITS, axis=-1)


def finish_layer(x, attn_o, pool_z, ga, gp, w_attn_up, w_pool_up, w_out,
                 g_post_mix, g_pre_mlp, g_post_mlp, w_mlp_up, w_mlp_down):
    a = attn_o @ w_attn_up
    p = pool_z @ w_pool_up
    m = jax.nn.sigmoid(ga) * a + jax.nn.sigmoid(gp) * p
    h = x + rms_norm(m @ w_out, g_post_mix)
    f = jnp.square(jax.nn.relu(rms_norm(h, g_pre_mlp) @ w_mlp_up)) @ w_mlp_down
    return h + rms_norm(f, g_post_mlp)


def setup_inputs(seed: int = 0) -> dict:
    key = jax.random.key(seed)
    ks = jax.random.split(key, 24)
    nrm = lambda k, shape, s: jax.random.normal(k, shape, jnp.float32) * s
    n_pages = PAST_LEN // PAGE_SIZE
    del n_pages
    return {
        "x_prompt": nrm(ks[0], (BATCH, SEQ, D_MODEL), 1.0),
        "x_sample": nrm(ks[1], (DEC_BATCH, DEC_SEQ, D_MODEL), 1.0),
        "cache_k_win": nrm(ks[2], (DEPTH, DEC_BATCH, WINDOW, N_KV_HEADS, HEAD_DIM), 1.0),
        "cache_v_win": nrm(ks[3], (DEPTH, DEC_BATCH, WINDOW, N_KV_HEADS, HEAD_DIM), 1.0),
        "state_pool": nrm(ks[4], (DEPTH, DEC_BATCH, POOL_STATE, POOL_WIDTH), 1.0),
        "norm_pre_mix": 1.0 + nrm(ks[5], (DEPTH, D_MODEL), 0.05),
        "norm_post_mix": 1.0 + nrm(ks[6], (DEPTH, D_MODEL), 0.05),
        "norm_pre_mlp": 1.0 + nrm(ks[7], (DEPTH, D_MODEL), 0.05),
        "norm_post_mlp": 1.0 + nrm(ks[8], (DEPTH, D_MODEL), 0.05),
        "w_in": nrm(ks[9], (DEPTH, D_MODEL, IN_WIDTH), D_MODEL ** -0.5),
        "b_in": nrm(ks[10], (DEPTH, IN_WIDTH), 0.02),
        "attn_sinks": nrm(ks[11], (DEPTH, N_HEADS), 0.5),
        "rel_bias_table": nrm(ks[12], (N_BUCKETS, N_HEADS), 0.5),
        "w_attn_up": nrm(ks[13], (DEPTH, ATTN_WIDTH, D_MODEL), ATTN_WIDTH ** -0.5),
        "w_pool_grp": nrm(ks[14], (DEPTH, N_POOL_GROUPS, POOL_GROUP_WIDTH, POOL_GROUP_WIDTH), POOL_GROUP_WIDTH ** -0.5),
        "pool_scale": 1.0 + nrm(ks[15], (DEPTH, POOL_WIDTH), 0.1),
        "w_pool_up": nrm(ks[16], (DEPTH, POOL_WIDTH, D_MODEL), POOL_WIDTH ** -0.5),
        "w_out": nrm(ks[17], (DEPTH, D_MODEL, D_MODEL), D_MODEL ** -0.5),
        "w_mlp_up": nrm(ks[18], (DEPTH, D_MODEL, D_FF), D_MODEL ** -0.5),
        "w_mlp_down": nrm(ks[19], (DEPTH, D_FF, D_MODEL), D_FF ** -0.5),
    }


def reference(x_prompt, x_sample, cache_k_win, cache_v_win, state_pool,
              norm_pre_mix, norm_post_mix, norm_pre_mlp, norm_post_mlp,
              w_in, b_in, attn_sinks, rel_bias_table, w_attn_up, w_pool_grp,
              pool_scale, w_pool_up, w_out, w_mlp_up, w_mlp_down):
    B, S, _ = x_prompt.shape
    NB = S // BLOCK
    DB, T, _ = x_sample.shape

    r = jnp.arange(BLOCK)[:, None]
    j = jnp.arange(2 * BLOCK)[None, :]
    dist_p = r + BLOCK - j
    key_pos_p = jnp.arange(NB)[:, None, None] * BLOCK - BLOCK + j[None]
    valid_p = (dist_p >= 0)[None] & (dist_p < WINDOW)[None] & (key_pos_p >= 0)
    bias_p = rel_bias(dist_p, rel_bias_table)

    i_s = jnp.arange(T)[:, None]
    j_s = jnp.arange(WINDOW + T)[None, :]
    dist_s = i_s + WINDOW - j_s
    valid_s = ((dist_s >= 0) & (dist_s < WINDOW) & (PAST_LEN - WINDOW + j_s >= 0))[None]
    bias_s = rel_bias(dist_s, rel_bias_table)

    def band(t):
        tp = jnp.pad(t, ((0, 0), (BLOCK, 0), (0, 0), (0, 0)))
        tp = tp.reshape(B, NB + 1, BLOCK, N_KV_HEADS, HEAD_DIM)
        return jnp.concatenate([tp[:, :-1], tp[:, 1:]], axis=2)

    hp, hs = x_prompt, x_sample
    kp_l, vp_l, pp_l, ks_l, vs_l, ps_l = [], [], [], [], [], []
    for l in range(DEPTH):
        tail = (w_attn_up[l], w_pool_up[l], w_out[l], norm_post_mix[l],
                norm_pre_mlp[l], norm_post_mlp[l], w_mlp_up[l], w_mlp_down[l])

        q, k, v, up, ga, gp = project_in(hp, norm_pre_mix[l], w_in[l], b_in[l])
        q = q.reshape(B, NB, BLOCK, N_KV_HEADS, GROUP, HEAD_DIM)
        k = k.reshape(B, S, N_KV_HEADS, HEAD_DIM)
        v = v.reshape(B, S, N_KV_HEADS, HEAD_DIM)
        o = window_attention(q, band(k), band(v), valid_p, bias_p, attn_sinks[l])
        o = o.reshape(B, S, ATTN_WIDTH)
        ext = jnp.pad(up, ((0, 0), (POOL_STATE, 0), (0, 0)))
        z = pool_mix(ext, 0, w_pool_grp[l], pool_scale[l])
        kp_l.append(k[:, -WINDOW:])
        vp_l.append(v[:, -WINDOW:])
        pp_l.append(up[:, -POOL_STATE:])
        hp = finish_layer(hp, o, z, ga, gp, *tail)

        q, k, v, up, ga, gp = project_in(hs, norm_pre_mix[l], w_in[l], b_in[l])
        q = q.reshape(DB, 1, T, N_KV_HEADS, GROUP, HEAD_DIM)
        kx = jnp.concatenate([cache_k_win[l], k.reshape(DB, T, N_KV_HEADS, HEAD_DIM)], axis=1)
        vx = jnp.concatenate([cache_v_win[l], v.reshape(DB, T, N_KV_HEADS, HEAD_DIM)], axis=1)
        o = window_attention(q, kx[:, None], vx[:, None], valid_s, bias_s, attn_sinks[l])
        o = o.reshape(DB, T, ATTN_WIDTH)
        ext = jnp.concatenate([state_pool[l], up], axis=1)
        z = pool_mix(ext, PAST_LEN, w_pool_grp[l], pool_scale[l])
        ks_l.append(kx[:, -WINDOW:])
        vs_l.append(vx[:, -WINDOW:])
        ps_l.append(ext[:, -POOL_STATE:])
        hs = finish_layer(hs, o, z, ga, gp, *tail)

    return (hp, hs, jnp.stack(kp_l), jnp.stack(vp_l), jnp.stack(pp_l),
            jnp.stack(ks_l), jnp.stack(vs_l), jnp.stack(ps_l))
```

```cpp
#include <hip/hip_runtime.h>
#include <hip/hip_cooperative_groups.h>
#include <cstdio>
#include <cstdint>
namespace cg = cooperative_groups;

#ifndef MK_ONE_LAUNCH
#define MK_ONE_LAUNCH 0
#endif

#define LAS __attribute__((address_space(3)))
#define GAS __attribute__((address_space(1)))
typedef unsigned short bf16_t;
typedef short bf16x8 __attribute__((ext_vector_type(8)));
typedef float f32x4 __attribute__((ext_vector_type(4)));
typedef float f32x2 __attribute__((ext_vector_type(2)));
typedef float f32x16 __attribute__((ext_vector_type(16)));
typedef unsigned u32x4 __attribute__((ext_vector_type(4)));
typedef unsigned u32x2 __attribute__((ext_vector_type(2)));
typedef __bf16 bf16x2_t __attribute__((ext_vector_type(2)));

constexpr int D = 1024, SEQ = 8192, NB_P = 4, NTOK_P = NB_P * SEQ, DB = 128, TS = 8, NTOK_S = DB * TS, M = NTOK_P + NTOK_S;
constexpr int INW = 3328, FF = 4096, WIN = 128, PST = 15, PW = 512;
constexpr int C_Q = 0, C_K = 512, C_V = 640, C_UP = 768, C_GA = 1280, C_GP = 2304;
constexpr float RMS_EPS = 1e-6f, LOG2E = 1.4426950408889634f, C2 = 0.125f * LOG2E, NEGBIG = -1e30f;
static_assert(M % 256 == 0, "M tiles");
constexpr size_t O_Y = 0, O_KWP = (size_t)M * D, O_VWP = O_KWP + 65536, O_PSP = O_VWP + 65536, O_KWS = O_PSP + 30720, O_VWS = O_KWS + 2097152, O_PSS = O_VWS + 2097152, O_END = O_PSS + 983040;
constexpr size_t MiB = 1u << 20;
constexpr size_t WS_CTL = 0, WS_WIN = 1 * MiB, WS_WAP = 8 * MiB, WS_WOUT = 10 * MiB, WS_WUP = 12 * MiB, WS_WDN = 20 * MiB, WS_WG = 28 * MiB, WS_BT = 28 * MiB + 256 * 1024;
constexpr size_t WS_BUF0 = 30 * MiB, WS_BUF2 = 96 * MiB, WS_BIG = 162 * MiB;
constexpr size_t WS_U = WS_BIG, WS_OZ = WS_U + (size_t)M * INW * 2, WS_END = WS_OZ + (size_t)M * D * 2;
constexpr size_t WS_T = WS_BIG, WS_HID = WS_BIG, WS_T2 = WS_BUF0;
static_assert(WS_BUF0 + (size_t)M * D * 2 <= WS_BUF2 && WS_BUF2 + (size_t)M * D * 2 <= WS_BIG && WS_HID + (size_t)M * FF * 2 <= WS_END && WS_T + (size_t)M * D * 4 <= WS_OZ && WS_T2 + (size_t)M * D * 4 <= WS_BIG, "ws map");

constexpr int NWAVES = 8, NTHR = 512, LDS_BYTES = 147456;

__device__ __forceinline__ unsigned cvtpk(float lo, float hi) { f32x2 v = {lo, hi}; bf16x2_t b = __builtin_convertvector(v, bf16x2_t); return __builtin_bit_cast(unsigned, b); }
__device__ __forceinline__ float bf2f(unsigned short b) { return __builtin_bit_cast(float, (unsigned)b << 16); }
__device__ __forceinline__ float bflo(unsigned w) { return __builtin_bit_cast(float, w << 16); }
__device__ __forceinline__ float bfhi(unsigned w) { return __builtin_bit_cast(float, w & 0xffff0000u); }
__device__ __forceinline__ float wave_sum(float v) {
#pragma unroll
    for (int o = 1; o < 64; o <<= 1) v += __shfl_xor(v, o);
    return v;
}

namespace pg8 {
#define PG8_LAS __attribute__((address_space(3)))
constexpr int BM = 256, BK = 64, HALF = 128, HTB = HALF * BK * 2, STAGE_BYTES = 8 * HTB, NXCD = 8, WGM = 8;
__host__ __device__ __forceinline__ int lds_byte(int r, int c) { const int st = (r >> 4) * 2 + (c >> 5), rr = r & 15, cc = c & 31, ob = rr * 64 + cc * 2; return st * 1024 + (ob ^ (((ob >> 9) & 1) << 5)); }
__host__ __device__ __forceinline__ void stage_rc(int b, int& R, int& C) { const int st = b / 1024, sb = b % 1024, swz = sb ^ (((sb >> 9) & 1) << 5); R = (st >> 1) * 16 + swz / 64; C = (st & 1) * 32 + (swz % 64) / 2; }
__host__ __device__ __forceinline__ int perm32(int rho) { const int n = rho >> 4, i = rho & 15; return 8 * (i >> 2) + 4 * n + (i & 3); }
struct Unit { int pm, pn; };
struct Gemm { const bf16_t* A; const bf16_t* Bt; int M, N, K; };
struct StaticOrder {
    int nM, nN, nwg, G, c;
    __device__ void init(int M_, int N_, int G_, int c_) { nM = M_ / BM; nN = N_ / BM; nwg = nM * nN; G = G_; c = c_; }
    __device__ bool next(int i, Unit& u) const {
        const long L = (long)i * G + c; if (L >= nwg) return false;
        int wgid = (int)L; { const int q = nwg / NXCD, r = nwg % NXCD, xcd = wgid % NXCD, off = wgid / NXCD; wgid = (xcd < r ? xcd * (q + 1) : r * (q + 1) + (xcd - r) * q) + off; }
        const int nig = WGM * nN, gid = wgid / nig, fm = gid * WGM, gsz = (nM - fm) < WGM ? (nM - fm) : WGM;
        u.pm = fm + ((wgid % nig) % gsz); u.pn = (wgid % nig) / gsz; return true;
    }
    __device__ __forceinline__ void a_ready(const Unit&) const {}
    __device__ __forceinline__ void done(const Unit&) const {}
};
struct Order4 {
    int nunits, G, c;
    __device__ bool next(int i, Unit& u) const { const int L = i * G + c; if (L >= nunits) return false; u.pm = L >> 2; u.pn = L & 3; return true; }
    __device__ __forceinline__ void a_ready(const Unit&) const {}
    __device__ __forceinline__ void done(const Unit&) const {}
};

template <class Epi, class Sched, bool ALIGN_EPI>
__device__ __forceinline__ void gemm_phase(PG8_LAS unsigned char* lds, const Gemm g, const Sched& S, const Epi& E) {
    const int tid = threadIdx.x, wid = __builtin_amdgcn_readfirstlane(tid >> 6), lane = tid & 63, wr = wid >> 2, wc = wid & 3, fr = lane & 15, fq = lane >> 4;
    const int K = g.K, nt = K / BK;
    unsigned voffA[2], voffB[2];
#pragma unroll
    for (int i = 0; i < 2; ++i) { int R, C; stage_rc(tid * 16 + i * 8192, R, C); const int Rb = Epi::PERM ? ((R & ~31) + perm32(R & 31)) : R;
        voffA[i] = (unsigned)(R * K + C) * 2u; voffB[i] = (unsigned)(Rb * K + C) * 2u; }
    const size_t kstep = (size_t)(BK * 2);
    const size_t hstep = (size_t)HALF * K * 2;
    const size_t tstep = 2 * hstep;
    const unsigned ldsw = (unsigned)wid * 1024u;
    const int aoff = lds_byte(wr * 64 + fr, fq * 8), boff = lds_byte(wc * 32 + fr, fq * 8);
#define PG8_SA(b, h) (((b) * 2 + (h)) * HTB)
#define PG8_SB(b, h) ((4 + (b) * 2 + (h)) * HTB)
#define PG8_STAGE(bufoff, gbase, voff) do { _Pragma("unroll") for (int _i = 0; _i < 2; ++_i) \
        __builtin_amdgcn_global_load_lds((const unsigned*)((const char*)(gbase) + (voff)[_i]), (PG8_LAS unsigned*)(lds + (bufoff) + ldsw + _i * 8192), 16, 0, 0); } while (0)
#define PG8_LDA(dst, b, h) do { _Pragma("unroll") for (int m = 0; m < 4; ++m) _Pragma("unroll") for (int k = 0; k < 2; ++k) dst[m][k] = *(const PG8_LAS bf16x8*)(lds + PG8_SA(b, h) + aoff + m * 2048 + k * 1024); } while (0)
#define PG8_LDB(dst, b, h) do { _Pragma("unroll") for (int n = 0; n < 2; ++n) _Pragma("unroll") for (int k = 0; k < 2; ++k) dst[n][k] = *(const PG8_LAS bf16x8*)(lds + PG8_SB(b, h) + boff + n * 2048 + k * 1024); } while (0)
#define PG8_MMA(ai, bj, At, Bt) do { __builtin_amdgcn_s_setprio(1); _Pragma("unroll") for (int m = 0; m < 4; ++m) _Pragma("unroll") for (int n = 0; n < 2; ++n) _Pragma("unroll") for (int k = 0; k < 2; ++k) \
        acc[ai][bj][m][n] = __builtin_amdgcn_mfma_f32_16x16x32_bf16(Bt[n][k], At[m][k], acc[ai][bj][m][n], 0, 0, 0); __builtin_amdgcn_s_setprio(0); } while (0)
#define PG8_WAIT_V(n) asm volatile("s_waitcnt vmcnt(" #n ")" ::: "memory")
#define PG8_WAIT_L(n) asm volatile("s_waitcnt lgkmcnt(" #n ")" ::: "memory")
#define PG8_BAR __builtin_amdgcn_s_barrier()
#define PG8_SCHED __builtin_amdgcn_sched_barrier(0)
    Unit cur, nxt; int ui = 0;
    if (!S.next(0, cur)) return;
    f32x4 acc[2][2][4][2];
#pragma unroll
    for (int a = 0; a < 2; ++a)
#pragma unroll
        for (int b = 0; b < 2; ++b)
#pragma unroll
            for (int m = 0; m < 4; ++m)
#pragma unroll
                for (int n = 0; n < 2; ++n) acc[a][b][m][n] = (f32x4){0.f, 0.f, 0.f, 0.f};
    bf16x8 At[4][2], B0[2][2], B1[2][2];
    const char* cA = (const char*)g.A + (size_t)cur.pm * tstep; const char* cB = (const char*)g.Bt + (size_t)cur.pn * tstep;
    S.a_ready(cur);
    PG8_STAGE(PG8_SB(0, 0), cB, voffB); PG8_STAGE(PG8_SB(0, 1), cB + hstep, voffB); PG8_STAGE(PG8_SA(0, 0), cA, voffA); PG8_STAGE(PG8_SA(0, 1), cA + hstep, voffA);
    if (wr == 1) PG8_BAR;
    PG8_WAIT_V(2); PG8_BAR;
    PG8_STAGE(PG8_SB(1, 0), cB + kstep, voffB); PG8_STAGE(PG8_SA(1, 0), cA + kstep, voffA); PG8_STAGE(PG8_SB(1, 1), cB + hstep + kstep, voffB);
    PG8_WAIT_V(6); PG8_BAR;
    for (;;) {
        const bool has_next = S.next(ui + 1, nxt);
        const char* nA = has_next ? (const char*)g.A + (size_t)nxt.pm * tstep : cA; const char* nB = has_next ? (const char*)g.Bt + (size_t)nxt.pn * tstep : cB;
        for (int t = 0; t < nt; t += 2) {
            const bool last = (t == nt - 2);
            const char* a1 = cA + (size_t)(t + 1) * kstep;
            const char* a2 = last ? nA : cA + (size_t)(t + 2) * kstep; const char* b2 = last ? nB : cB + (size_t)(t + 2) * kstep;
            const char* a3 = a2 + kstep; const char* b3 = b2 + kstep;
            if (last && has_next) S.a_ready(nxt);
            if constexpr (Epi::HAS_MID) { if (t == (nt >> 1)) E.mid(acc, cur, wr, wc, fr, fq); }
            PG8_LDB(B0, 0, 0); PG8_LDB(B1, 0, 1); PG8_SCHED; PG8_LDA(At, 0, 0); PG8_STAGE(PG8_SA(1, 1), a1 + hstep, voffA);
            PG8_WAIT_V(8); PG8_WAIT_L(0); PG8_BAR; PG8_MMA(0, 0, At, B0); PG8_MMA(0, 1, At, B1); PG8_BAR; PG8_SCHED;
            PG8_LDA(At, 0, 1); PG8_STAGE(PG8_SB(0, 0), b2, voffB); PG8_STAGE(PG8_SB(0, 1), b2 + hstep, voffB); PG8_STAGE(PG8_SA(0, 0), a2, voffA);
            PG8_WAIT_V(8); PG8_WAIT_L(0); PG8_BAR; PG8_MMA(1, 0, At, B0); PG8_MMA(1, 1, At, B1); PG8_BAR; PG8_SCHED;
            PG8_LDB(B0, 1, 0); PG8_LDB(B1, 1, 1); PG8_SCHED; PG8_LDA(At, 1, 0); PG8_STAGE(PG8_SA(0, 1), a2 + hstep, voffA);
            PG8_WAIT_V(8); PG8_WAIT_L(0); PG8_BAR; PG8_MMA(0, 0, At, B0); PG8_MMA(0, 1, At, B1); PG8_BAR; PG8_SCHED;
            PG8_LDA(At, 1, 1); PG8_STAGE(PG8_SB(1, 0), b3, voffB); PG8_STAGE(PG8_SB(1, 1), b3 + hstep, voffB); PG8_STAGE(PG8_SA(1, 0), a3, voffA);
            PG8_WAIT_V(8); PG8_WAIT_L(0); PG8_BAR; PG8_MMA(1, 0, At, B0); PG8_MMA(1, 1, At, B1); PG8_BAR; PG8_SCHED;
        }
        if constexpr (ALIGN_EPI) { if (wr == 0) PG8_BAR; }
        E(acc, cur, wr, wc, fr, fq); S.done(cur);
        if (!has_next) break;
#pragma unroll
        for (int a = 0; a < 2; ++a)
#pragma unroll
            for (int b = 0; b < 2; ++b)
#pragma unroll
                for (int m = 0; m < 4; ++m)
#pragma unroll
                    for (int n = 0; n < 2; ++n) acc[a][b][m][n] = (f32x4){0.f, 0.f, 0.f, 0.f};
        cur = nxt; cA = nA; cB = nB; ++ui;
        if constexpr (ALIGN_EPI) { if (wr == 1) PG8_BAR; }
    }
    PG8_WAIT_V(0);
    if constexpr (!ALIGN_EPI) { if (wr == 0) PG8_BAR; }
    PG8_BAR;
#undef PG8_SA
#undef PG8_SB
#undef PG8_STAGE
#undef PG8_LDA
#undef PG8_LDB
#undef PG8_MMA
#undef PG8_WAIT_V
#undef PG8_WAIT_L
#undef PG8_BAR
#undef PG8_SCHED
}

__device__ __forceinline__ float sigmoidf_(float v) { return __builtin_amdgcn_rcpf(1.0f + __builtin_amdgcn_exp2f(-LOG2E * v)); }
struct EpiIn {
    static constexpr bool PERM = true, HAS_MID = false;
    bf16_t* U; const float* bias;
    __device__ __forceinline__ void mid(f32x4 (&)[2][2][4][2], const Unit&, int, int, int, int) const {}
    __device__ __forceinline__ void operator()(const f32x4 (&acc)[2][2][4][2], const Unit& u, int wr, int wc, int fr, int fq) const {
        const int row0 = u.pm * BM + wr * 64 + fr, col0 = u.pn * BM + wc * 32 + 8 * fq;
        const int mode = u.pn < 2 ? 0 : (u.pn < 5 ? 1 : 2);
        f32x4 bv[2][2];
#pragma unroll
        for (int bj = 0; bj < 2; ++bj)
#pragma unroll
            for (int n = 0; n < 2; ++n) bv[bj][n] = *(const f32x4*)(bias + col0 + bj * HALF + 4 * n);
#pragma unroll
        for (int ai = 0; ai < 2; ++ai)
#pragma unroll
            for (int m = 0; m < 4; ++m) { bf16_t* rowp = U + (size_t)(row0 + ai * HALF + m * 16) * INW + col0;
#pragma unroll
                for (int bj = 0; bj < 2; ++bj) { f32x4 v0 = acc[ai][bj][m][0] + bv[bj][0], v1 = acc[ai][bj][m][1] + bv[bj][1];
                    if (mode == 0) { v0 = v0 * C2; v1 = v1 * C2; }
                    else if (mode == 2) {
#pragma unroll
                        for (int e = 0; e < 4; ++e) { v0[e] = sigmoidf_(v0[e]); v1[e] = sigmoidf_(v1[e]); } }
                    u32x4 w; w.x = cvtpk(v0[0], v0[1]); w.y = cvtpk(v0[2], v0[3]); w.z = cvtpk(v1[0], v1[1]); w.w = cvtpk(v1[2], v1[3]);
                    *(u32x4*)(rowp + bj * HALF) = w; } }
    }
};
struct EpiGate {
    static constexpr bool PERM = true, HAS_MID = true;
    const bf16_t* U; bf16_t* Mo;
    __device__ __forceinline__ void mid(f32x4 (&acc)[2][2][4][2], const Unit& u, int wr, int wc, int fr, int fq) const {
        int fro = fr; asm volatile("" : "+v"(fro));
        const int row0 = u.pm * BM + wr * 64 + fro, col0 = u.pn * BM + wc * 32 + 8 * fq;
#pragma unroll
        for (int ai = 0; ai < 2; ++ai)
#pragma unroll
            for (int m = 0; m < 4; ++m) { const bf16_t* rowp = U + (size_t)(row0 + ai * HALF + m * 16) * INW + col0;
#pragma unroll
                for (int bj = 0; bj < 2; ++bj) { const u32x4 a = *(const u32x4*)(rowp + C_GA + bj * HALF), p = *(const u32x4*)(rowp + C_GP + bj * HALF);
                    f32x4 r0, r1;
                    r0[0] = bflo(a.x) * __builtin_amdgcn_rcpf(bflo(p.x)); r0[1] = bfhi(a.x) * __builtin_amdgcn_rcpf(bfhi(p.x)); r0[2] = bflo(a.y) * __builtin_amdgcn_rcpf(bflo(p.y)); r0[3] = bfhi(a.y) * __builtin_amdgcn_rcpf(bfhi(p.y));
                    r1[0] = bflo(a.z) * __builtin_amdgcn_rcpf(bflo(p.z)); r1[1] = bfhi(a.z) * __builtin_amdgcn_rcpf(bfhi(p.z)); r1[2] = bflo(a.w) * __builtin_amdgcn_rcpf(bflo(p.w)); r1[3] = bfhi(a.w) * __builtin_amdgcn_rcpf(bfhi(p.w));
                    acc[ai][bj][m][0] = acc[ai][bj][m][0] * r0; acc[ai][bj][m][1] = acc[ai][bj][m][1] * r1; }
                asm volatile("" : "+v"(acc[ai][0][m][0]), "+v"(acc[ai][0][m][1]), "+v"(acc[ai][1][m][0]), "+v"(acc[ai][1][m][1]));
                if (m & 1) asm volatile("" ::: "memory"); }
    }
    __device__ __forceinline__ void operator()(const f32x4 (&acc)[2][2][4][2], const Unit& u, int wr, int wc, int fr, int fq) const {
        int fro = fr; asm volatile("" : "+v"(fro));
        const int row0 = u.pm * BM + wr * 64 + fro, col0 = u.pn * BM + wc * 32 + 8 * fq;
#pragma unroll
        for (int ai = 0; ai < 2; ++ai)
#pragma unroll
            for (int m = 0; m < 4; ++m) { const size_t row = (size_t)(row0 + ai * HALF + m * 16); const bf16_t* gp = U + row * INW + C_GP + col0; bf16_t* op = Mo + row * D + col0;
#pragma unroll
                for (int bj = 0; bj < 2; ++bj) { const u32x4 p = *(const u32x4*)(gp + bj * HALF); const f32x4 v0 = acc[ai][bj][m][0], v1 = acc[ai][bj][m][1];
                    u32x4 w; w.x = cvtpk(v0[0] * bflo(p.x), v0[1] * bfhi(p.x)); w.y = cvtpk(v0[2] * bflo(p.y), v0[3] * bfhi(p.y));
                    w.z = cvtpk(v1[0] * bflo(p.z), v1[1] * bfhi(p.z)); w.w = cvtpk(v1[2] * bflo(p.w), v1[3] * bfhi(p.w));
                    *(u32x4*)(op + bj * HALF) = w; }
                if (m & 1) asm volatile("" ::: "memory"); }
    }
};
struct EpiF32 {
    static constexpr bool PERM = false, HAS_MID = false;
    float* O; int ldc;
    __device__ __forceinline__ void mid(f32x4 (&)[2][2][4][2], const Unit&, int, int, int, int) const {}
    __device__ __forceinline__ void operator()(const f32x4 (&acc)[2][2][4][2], const Unit& u, int wr, int wc, int fr, int fq) const {
        const int row0 = u.pm * BM + wr * 64 + fr, col0 = u.pn * BM + wc * 32 + 4 * fq;
#pragma unroll
        for (int ai = 0; ai < 2; ++ai)
#pragma unroll
            for (int m = 0; m < 4; ++m) { float* rowp = O + (size_t)(row0 + ai * HALF + m * 16) * ldc + col0;
#pragma unroll
                for (int bj = 0; bj < 2; ++bj)
#pragma unroll
                    for (int n = 0; n < 2; ++n) *(f32x4*)(rowp + bj * HALF + n * 16) = acc[ai][bj][m][n]; }
    }
};
struct EpiRelu2 {
    static constexpr bool PERM = true, HAS_MID = false;
    bf16_t* O;
    __device__ __forceinline__ void mid(f32x4 (&)[2][2][4][2], const Unit&, int, int, int, int) const {}
    __device__ __forceinline__ void operator()(const f32x4 (&acc)[2][2][4][2], const Unit& u, int wr, int wc, int fr, int fq) const {
        const int row0 = u.pm * BM + wr * 64 + fr, col0 = u.pn * BM + wc * 32 + 8 * fq;
#pragma unroll
        for (int ai = 0; ai < 2; ++ai)
#pragma unroll
            for (int m = 0; m < 4; ++m) { bf16_t* rowp = O + (size_t)(row0 + ai * HALF + m * 16) * FF + col0;
#pragma unroll
                for (int bj = 0; bj < 2; ++bj) { f32x4 v0 = acc[ai][bj][m][0], v1 = acc[ai][bj][m][1];
#pragma unroll
                    for (int e = 0; e < 4; ++e) { const float a = fmaxf(v0[e], 0.f), b = fmaxf(v1[e], 0.f); v0[e] = a * a; v1[e] = b * b; }
                    u32x4 w; w.x = cvtpk(v0[0], v0[1]); w.y = cvtpk(v0[2], v0[3]); w.z = cvtpk(v1[0], v1[1]); w.w = cvtpk(v1[2], v1[3]);
                    *(u32x4*)(rowp + bj * HALF) = w; } }
    }
};
}

struct Params { const float* in[20]; float* out; unsigned char* ws; int ph_lo, ph_hi; };
enum { I_XP = 0, I_XS, I_CK, I_CV, I_SP, I_G0, I_G1, I_G2, I_G3, I_WIN, I_BIN, I_SINK, I_RBT, I_WAU, I_WPG, I_PSC, I_WPU, I_WOUT, I_WUP, I_WDN };

__device__ __forceinline__ const float* xrow(const Params& P, int m) { return m < NTOK_P ? P.in[I_XP] + (size_t)m * D : P.in[I_XS] + (size_t)(m - NTOK_P) * D; }

__device__ __forceinline__ void p0_transpose_item(const float* W, int N, bf16_t* WT, int row_off, int ldk, int koff, LAS float* scr, int item, int lane) {
    const int nblk = N / 32, kb = item / nblk, nb = item % nblk, k0 = 64 * kb, n0 = 32 * nb;
#pragma unroll 8
    for (int i = 0; i < 32; ++i) { const int kk = 2 * i + (lane >> 5); scr[kk * 33 + (lane & 31)] = W[(size_t)(k0 + kk) * N + n0 + (lane & 31)]; }
    asm volatile("s_waitcnt lgkmcnt(0)" ::: "memory");
    const int c = lane & 7;
#pragma unroll
    for (int j = 0; j < 4; ++j) { const int n = (lane >> 3) + 8 * j; const LAS float* s = scr + (8 * c) * 33 + n;
        u32x4 o; o.x = cvtpk(s[0 * 33], s[1 * 33]); o.y = cvtpk(s[2 * 33], s[3 * 33]); o.z = cvtpk(s[4 * 33], s[5 * 33]); o.w = cvtpk(s[6 * 33], s[7 * 33]);
        *(u32x4*)(WT + (size_t)(row_off + n0 + n) * ldk + koff + k0 + 8 * c) = o; }
    asm volatile("s_waitcnt lgkmcnt(0)" ::: "memory");
}
__device__ __forceinline__ void p0_prologue(const Params& P, LAS unsigned char* lds, int vcu, int G, int wave, int lane) {
    unsigned char* ws = P.ws;
    LAS float* scr = (LAS float*)(lds + wave * 16384);
    const int gw = vcu * NWAVES + wave, NGW = G * NWAVES;
    constexpr int I_0 = (D / 64) * (INW / 32), I_1 = (512 / 64) * (D / 32), I_2 = I_1, I_3 = (D / 64) * (D / 32), I_4 = (D / 64) * (FF / 32), I_5 = (FF / 64) * (D / 32), I_6 = 4 * (128 / 64) * (128 / 32);
    constexpr int NITEMS = I_0 + I_1 + I_2 + I_3 + I_4 + I_5 + I_6;
    for (int it = gw; it < NITEMS; it += NGW) {
        int r = it;
        if (r < I_0) { p0_transpose_item(P.in[I_WIN], INW, (bf16_t*)(ws + WS_WIN), 0, D, 0, scr, r, lane); continue; } r -= I_0;
        if (r < I_1) { p0_transpose_item(P.in[I_WAU], D, (bf16_t*)(ws + WS_WAP), 0, D, 0, scr, r, lane); continue; } r -= I_1;
        if (r < I_2) { p0_transpose_item(P.in[I_WPU], D, (bf16_t*)(ws + WS_WAP), 0, D, 512, scr, r, lane); continue; } r -= I_2;
        if (r < I_3) { p0_transpose_item(P.in[I_WOUT], D, (bf16_t*)(ws + WS_WOUT), 0, D, 0, scr, r, lane); continue; } r -= I_3;
        if (r < I_4) { p0_transpose_item(P.in[I_WUP], FF, (bf16_t*)(ws + WS_WUP), 0, D, 0, scr, r, lane); continue; } r -= I_4;
        if (r < I_5) { p0_transpose_item(P.in[I_WDN], D, (bf16_t*)(ws + WS_WDN), 0, FF, 0, scr, r, lane); continue; } r -= I_5;
        { const int g = r / 8, rr = r % 8; p0_transpose_item(P.in[I_WPG] + (size_t)g * 16384, 128, (bf16_t*)(ws + WS_WG) + (size_t)g * 16384, 0, 128, 0, scr, rr, lane); }
    }
    const float* g0 = P.in[I_G0]; bf16_t* XN = (bf16_t*)(ws + WS_BUF0);
    f32x4 gv[4];
#pragma unroll
    for (int j = 0; j < 4; ++j) gv[j] = *(const f32x4*)(g0 + 4 * lane + 256 * j);
    for (int m = gw; m < M; m += NGW) {
        const f32x4* xr = (const f32x4*)xrow(P, m) + lane;
        f32x4 v[4]; float s = 0.f;
#pragma unroll
        for (int j = 0; j < 4; ++j) { v[j] = xr[64 * j]; s += (v[j].x * v[j].x + v[j].y * v[j].y) + (v[j].z * v[j].z + v[j].w * v[j].w); }
        const float rs = 1.0f / sqrtf(wave_sum(s) * (1.f / D) + RMS_EPS);
        u32x2* o8 = (u32x2*)(XN + (size_t)m * D) + lane;
#pragma unroll
        for (int j = 0; j < 4; ++j) { u32x2 w; w.x = cvtpk(v[j].x * rs * gv[j].x, v[j].y * rs * gv[j].y); w.y = cvtpk(v[j].z * rs * gv[j].z, v[j].w * rs * gv[j].w); o8[64 * j] = w; }
    }
    if (vcu == 0) {
        float* BT = (float*)(ws + WS_BT); const float* rbt = P.in[I_RBT];
        for (int e = threadIdx.x; e < 8 * 256; e += NTHR) { const int h = e >> 8, dist = (e & 255) - 64; float v = NEGBIG;
            if (dist >= 0 && dist < WIN) { int b = dist; if (dist >= 16) { b = 16 + (int)(logf((float)dist * (1.0f / 16.0f)) / 2.0794415416798357f * 16.0f); b = b > 31 ? 31 : b; } v = rbt[b * 8 + h] * LOG2E; }
            BT[e] = v; }
    }
}

constexpr int KS_PITCH = 144, VT_PITCH = 520, ATT_KS = 0, ATT_VT = 256 * KS_PITCH, ATT_BT = ATT_VT + 64 * VT_PITCH;
static_assert(ATT_BT + 8192 <= 131072, "attention LDS");
__device__ __forceinline__ void attn_strip(LAS const unsigned char* KS, LAS const unsigned char* VT, LAS const float* BTl, int kt0, bool skip_lo,
                                           const bf16_t* qptr, int bt_idx, float sink2, bf16_t* obase, int qmask, int qshift, int lane) {
    const int r = lane & 31, h = lane >> 5;
    bf16x8 qf[4];
#pragma unroll
    for (int ks = 0; ks < 4; ++ks) qf[ks] = *(const bf16x8*)(qptr + ks * 16 + h * 8);
    f32x16 s[6];
#pragma unroll
    for (int kt = 0; kt < 6; ++kt) {
        const int j0 = 64 * kt0 + 32 * kt;
        f32x16 a;
#pragma unroll
        for (int t = 0; t < 16; ++t) a[t] = 0.f;
        asm volatile("" : "+v"(a));
        if (skip_lo && j0 < 128) {
#pragma unroll
            for (int t = 0; t < 16; ++t) a[t] = NEGBIG;
        } else {
#pragma unroll
            for (int ks = 0; ks < 4; ++ks) { const bf16x8 kf = *(LAS const bf16x8*)(KS + (j0 + r) * KS_PITCH + ks * 32 + h * 16); a = __builtin_amdgcn_mfma_f32_32x32x16_bf16(kf, qf[ks], a, 0, 0, 0); }
            LAS const float* bp = BTl + bt_idx - 32 * kt;
#pragma unroll
            for (int t = 0; t < 16; ++t) a[t] += bp[-((t & 3) + 8 * (t >> 2))];
        }
        s[kt] = a;
        __builtin_amdgcn_sched_barrier(0);
    }
    float mx = sink2;
#pragma unroll
    for (int kt = 0; kt < 6; ++kt)
#pragma unroll
        for (int t = 0; t < 16; ++t) mx = fmaxf(mx, s[kt][t]);
    mx = fmaxf(mx, __shfl_xor(mx, 32));
    float sum = 0.f;
#pragma unroll
    for (int kt = 0; kt < 6; ++kt)
#pragma unroll
        for (int t = 0; t < 16; ++t) { const float p = __builtin_amdgcn_exp2f(s[kt][t] - mx); s[kt][t] = p; sum += p; }
    sum += __shfl_xor(sum, 32);
    const float inv = 1.0f / (sum + __builtin_amdgcn_exp2f(sink2 - mx));
    f32x16 o[2];
#pragma unroll
    for (int t = 0; t < 16; ++t) { o[0][t] = 0.f; o[1][t] = 0.f; }
    asm volatile("" : "+v"(o[0]), "+v"(o[1]));
#pragma unroll
    for (int kt = 0; kt < 6; ++kt) {
        const int j0 = 64 * kt0 + 32 * kt;
        if (skip_lo && j0 < 128) continue;
#pragma unroll
        for (int s2 = 0; s2 < 2; ++s2) {
            u32x4 pw;
            pw.x = cvtpk(s[kt][8 * s2 + 0] * inv, s[kt][8 * s2 + 1] * inv); pw.y = cvtpk(s[kt][8 * s2 + 2] * inv, s[kt][8 * s2 + 3] * inv);
            pw.z = cvtpk(s[kt][8 * s2 + 4] * inv, s[kt][8 * s2 + 5] * inv); pw.w = cvtpk(s[kt][8 * s2 + 6] * inv, s[kt][8 * s2 + 7] * inv);
            const bf16x8 pa = __builtin_bit_cast(bf16x8, pw);
#pragma unroll
            for (int db = 0; db < 2; ++db) {
                LAS const unsigned char* vp = VT + (db * 32 + r) * VT_PITCH + (j0 + 16 * s2 + 4 * h) * 2;
                const u32x2 lo = *(LAS const u32x2*)vp, hi = *(LAS const u32x2*)(vp + 16);
                u32x4 vw; vw.x = lo.x; vw.y = lo.y; vw.z = hi.x; vw.w = hi.y;
                o[db] = __builtin_amdgcn_mfma_f32_32x32x16_bf16(pa, __builtin_bit_cast(bf16x8, vw), o[db], 0, 0, 0);
            }
            __builtin_amdgcn_sched_barrier(0);
        }
    }
    int hv = h; asm volatile("" : "+v"(hv));
#pragma unroll
    for (int t = 0; t < 16; ++t) { const int q = (t & 3) + 8 * (t >> 2) + 4 * hv; bf16_t* op = obase + (size_t)(q & qmask) * D + (q >> qshift) * 64 + r;
        op[0] = (bf16_t)(cvtpk(o[0][t], 0.f) & 0xffffu); op[32] = (bf16_t)(cvtpk(o[1][t], 0.f) & 0xffffu); }
}
__device__ __forceinline__ void stage_kv2(LAS unsigned char* KS, LAS unsigned char* VT, int rp, int ch, u32x4 k0, u32x4 k1, u32x4 v0, u32x4 v1) {
    *(LAS u32x4*)(KS + (2 * rp) * KS_PITCH + ch * 16) = k0;
    *(LAS u32x4*)(KS + (2 * rp + 1) * KS_PITCH + ch * 16) = k1;
    LAS unsigned* vt = (LAS unsigned*)(VT + (ch * 8) * VT_PITCH + rp * 4);
    vt[0 * (VT_PITCH / 4)] = (v0.x & 0xffffu) | (v1.x << 16); vt[1 * (VT_PITCH / 4)] = (v0.x >> 16) | (v1.x & 0xffff0000u);
    vt[2 * (VT_PITCH / 4)] = (v0.y & 0xffffu) | (v1.y << 16); vt[3 * (VT_PITCH / 4)] = (v0.y >> 16) | (v1.y & 0xffff0000u);
    vt[4 * (VT_PITCH / 4)] = (v0.z & 0xffffu) | (v1.z << 16); vt[5 * (VT_PITCH / 4)] = (v0.z >> 16) | (v1.z & 0xffff0000u);
    vt[6 * (VT_PITCH / 4)] = (v0.w & 0xffffu) | (v1.w << 16); vt[7 * (VT_PITCH / 4)] = (v0.w >> 16) | (v1.w & 0xffff0000u);
}
__device__ __forceinline__ void load_bt(const Params& P, LAS unsigned char* lds) {
    const float* BT = (const float*)(P.ws + WS_BT); LAS float* BTl = (LAS float*)(lds + ATT_BT);
    for (int e = threadIdx.x; e < 2048; e += NTHR) BTl[e] = BT[e];
}
__device__ __forceinline__ u32x4 pack8(const f32x4 a, const f32x4 b) { u32x4 w; w.x = cvtpk(a.x, a.y); w.y = cvtpk(a.z, a.w); w.z = cvtpk(b.x, b.y); w.w = cvtpk(b.z, b.w); return w; }
__device__ __forceinline__ void attn_unit(const Params& P, LAS unsigned char* lds, bool prompt, int unit, int wave, int lane, int tx) {
    const bf16_t* U = (const bf16_t*)(P.ws + WS_U); bf16_t* OZ = (bf16_t*)(P.ws + WS_OZ);
    LAS unsigned char* KS = lds + ATT_KS; LAS unsigned char* VT = lds + ATT_VT; LAS const float* BTl = (LAS const float*)(lds + ATT_BT);
    const int kvh = unit & 1;
    __syncthreads();
    if (prompt) {
        const int n = (unit >> 1) & 63, b = unit >> 7;
        const long mk0 = (long)b * SEQ + (long)(n - 1) * WIN;
#pragma unroll
        for (int i = 0; i < 2; ++i) { const int c = tx + NTHR * i, ch = c >> 7, rp = c & 127;
            u32x4 k0 = (u32x4){0u, 0u, 0u, 0u}, k1 = k0, v0 = k0, v1 = k0;
            if (n > 0 || rp >= WIN / 2) { const bf16_t* src = U + (size_t)(mk0 + 2 * rp) * INW + kvh * 64 + ch * 8;
                k0 = *(const u32x4*)(src + C_K); v0 = *(const u32x4*)(src + C_V); k1 = *(const u32x4*)(src + INW + C_K); v1 = *(const u32x4*)(src + INW + C_V); }
            stage_kv2(KS, VT, rp, ch, k0, k1, v0, v1); }
    } else {
        const int db = unit >> 1;
        const float* ck = P.in[I_CK] + (size_t)db * WIN * 128 + kvh * 64; const float* cv = P.in[I_CV] + (size_t)db * WIN * 128 + kvh * 64;
#pragma unroll
        for (int i = 0; i < 2; ++i) { const int c = tx + NTHR * i, ch = c / 96, rp = c % 96;
            if (c < 768) {
                u32x4 k0 = (u32x4){0u, 0u, 0u, 0u}, k1 = k0, v0 = k0, v1 = k0;
                if (rp < WIN / 2) { const float* a = ck + (size_t)(2 * rp) * 128 + ch * 8; const float* bq = cv + (size_t)(2 * rp) * 128 + ch * 8;
                    k0 = pack8(*(const f32x4*)a, *(const f32x4*)(a + 4)); v0 = pack8(*(const f32x4*)bq, *(const f32x4*)(bq + 4));
                    k1 = pack8(*(const f32x4*)(a + 128), *(const f32x4*)(a + 132)); v1 = pack8(*(const f32x4*)(bq + 128), *(const f32x4*)(bq + 132)); }
                else if (rp < (WIN + TS) / 2) { const bf16_t* src = U + (size_t)(NTOK_P + db * TS + 2 * rp - WIN) * INW + kvh * 64 + ch * 8;
                    k0 = *(const u32x4*)(src + C_K); v0 = *(const u32x4*)(src + C_V); k1 = *(const u32x4*)(src + INW + C_K); v1 = *(const u32x4*)(src + INW + C_V); }
                stage_kv2(KS, VT, rp, ch, k0, k1, v0, v1); } }
    }
    __syncthreads();
    asm volatile("" : "+v"(lane));
    const int r = lane & 31, h = lane >> 5;
    const int nstr = prompt ? (wave < 4 ? 4 : 0) : (wave == 0 ? 1 : 0);
#pragma unroll 1
    for (int sidx = 0; sidx < nstr; ++sidx) {
        int hq, rq, kt0, qmask, qshift; long mq, mo; bool skip_lo;
        if (prompt) { const int n = (unit >> 1) & 63, b = unit >> 7; const int q0 = sidx * 32; hq = kvh * 4 + wave; rq = q0 + r; kt0 = q0 >= 64 ? 1 : 0;
            mo = (long)b * SEQ + (long)n * WIN + q0; mq = mo + r; qmask = 31; qshift = 5; skip_lo = (n == 0); }
        else { const int db = unit >> 1; hq = kvh * 4 + (r >> 3); rq = r & 7; kt0 = 0; mo = NTOK_P + db * TS; mq = mo + rq; qmask = 7; qshift = 3; skip_lo = false; }
        const int hbase = prompt ? hq : kvh * 4;
        attn_strip(KS, VT, BTl, kt0, skip_lo, U + (size_t)mq * INW + C_Q + hq * 64, hq * 256 + rq + 192 - 64 * kt0 - 4 * h, P.in[I_SINK][hq] * LOG2E,
                   OZ + (size_t)mo * D + hbase * 64, qmask, qshift, lane);
    }
}
__device__ __forceinline__ void pool_unit(const Params& P, int tile, int wave, int lane) {
    const bf16_t* U = (const bf16_t*)(P.ws + WS_U); bf16_t* OZ = (bf16_t*)(P.ws + WS_OZ); const bf16_t* WG = (const bf16_t*)(P.ws + WS_WG);
    const int g = wave >> 1, half = wave & 1, r = lane & 31, h = lane >> 5, wlen = 2 << g;
    const int m0 = tile * 64 + half * 32, m = m0 + r;
    const bool samp = m0 >= NTOK_P;
    int t, seq0; float rc;
    if (!samp) { t = m & (SEQ - 1); seq0 = m - t; const int cnt = (t + 1) < wlen ? (t + 1) : wlen; rc = 1.0f / (float)cnt; }
    else { t = (m - NTOK_P) & 7; seq0 = m - t; rc = 1.0f / (float)wlen; }
    const float* sp = P.in[I_SP] + (size_t)((m - NTOK_P) >> 3) * PST * PW;
    f32x16 acc[4];
#pragma unroll
    for (int nb = 0; nb < 4; ++nb)
#pragma unroll
        for (int e = 0; e < 16; ++e) acc[nb][e] = 0.f;
    asm volatile("" : "+v"(acc[0]), "+v"(acc[1]), "+v"(acc[2]), "+v"(acc[3]));
#pragma unroll 1
    for (int ks = 0; ks < 8; ++ks) {
        const int c = g * 128 + ks * 16 + h * 8;
        float sum[8], cur[8];
#pragma unroll
        for (int e = 0; e < 8; ++e) { sum[e] = 0.f; cur[e] = 0.f; }
#pragma unroll 4
        for (int k = 0; k < wlen; ++k) {
            const int tt = t - k; float v[8];
            if (tt >= 0) { const u32x4 w = *(const u32x4*)(U + (size_t)(seq0 + tt) * INW + C_UP + c);
                v[0] = bflo(w.x); v[1] = bfhi(w.x); v[2] = bflo(w.y); v[3] = bfhi(w.y); v[4] = bflo(w.z); v[5] = bfhi(w.z); v[6] = bflo(w.w); v[7] = bfhi(w.w); }
            else if (samp) { const float* s = sp + (size_t)(PST + tt) * PW + c; const f32x4 a = *(const f32x4*)s, b = *(const f32x4*)(s + 4);
                v[0] = a.x; v[1] = a.y; v[2] = a.z; v[3] = a.w; v[4] = b.x; v[5] = b.y; v[6] = b.z; v[7] = b.w; }
            else {
#pragma unroll
                for (int e = 0; e < 8; ++e) v[e] = 0.f; }
#pragma unroll
            for (int e = 0; e < 8; ++e) { sum[e] += v[e]; if (k == 0) cur[e] = v[e]; }
        }
        u32x4 aw; aw.x = cvtpk(sum[0] * rc - cur[0], sum[1] * rc - cur[1]); aw.y = cvtpk(sum[2] * rc - cur[2], sum[3] * rc - cur[3]);
        aw.z = cvtpk(sum[4] * rc - cur[4], sum[5] * rc - cur[5]); aw.w = cvtpk(sum[6] * rc - cur[6], sum[7] * rc - cur[7]);
        const bf16x8 af = __builtin_bit_cast(bf16x8, aw);
#pragma unroll
        for (int nb = 0; nb < 4; ++nb) { const bf16x8 bfr = *(const bf16x8*)(WG + (size_t)g * 16384 + (nb * 32 + r) * 128 + ks * 16 + h * 8);
            acc[nb] = __builtin_amdgcn_mfma_f32_32x32x16_bf16(af, bfr, acc[nb], 0, 0, 0); }
    }
    asm volatile("s_nop 15\n\ts_nop 15" : "+v"(acc[0]), "+v"(acc[1]), "+v"(acc[2]), "+v"(acc[3]));
    const float* psc = P.in[I_PSC] + g * 128;
#pragma unroll
    for (int nb = 0; nb < 4; ++nb) { const float sc = psc[nb * 32 + r];
#pragma unroll
        for (int e = 0; e < 16; ++e) { const int q = (e & 3) + 8 * (e >> 2) + 4 * h;
            OZ[(size_t)(m0 + q) * D + 512 + g * 128 + nb * 32 + r] = (bf16_t)(cvtpk(acc[nb][e] * sc, 0.f) & 0xffffu); } }
}
constexpr int CP_A = 65536 / 4, CP_B = CP_A + 65536 / 4, CP_C = CP_B + 30720 / 4, CP_D = CP_C + 2097152 / 4, CP_E = CP_D + 2097152 / 4, CP_F = CP_E + 983040 / 4;
constexpr int CP_CHUNK = 2048, CP_NCHUNK = (CP_F + CP_CHUNK - 1) / CP_CHUNK;
__device__ __forceinline__ f32x4 ld_bf4(const bf16_t* p) { const u32x2 w = *(const u32x2*)p; return (f32x4){bflo(w.x), bfhi(w.x), bflo(w.y), bfhi(w.y)}; }
__device__ __forceinline__ void copy_chunk(const Params& P, int chunk, int tx) {
    const bf16_t* U = (const bf16_t*)(P.ws + WS_U); float* out = P.out;
#pragma unroll 1
    for (int i = 0; i < CP_CHUNK / NTHR; ++i) {
        int e = chunk * CP_CHUNK + i * NTHR + tx; if (e >= CP_F) break;
        f32x4 v; float* dst;
        if (e < CP_B) { const bool isv = e >= CP_A; if (isv) e -= CP_A; const int c = (e & 31) * 4, rr = (e >> 5) & 127, b = e >> 12;
            v = ld_bf4(U + (size_t)(b * SEQ + SEQ - WIN + rr) * INW + (isv ? C_V : C_K) + c); dst = out + (isv ? O_VWP : O_KWP) + (size_t)e * 4; }
        else if (e < CP_C) { e -= CP_B; const int c = (e & 127) * 4, q = e >> 7, rr = q % PST, b = q / PST;
            v = ld_bf4(U + (size_t)(b * SEQ + SEQ - PST + rr) * INW + C_UP + c); dst = out + O_PSP + (size_t)e * 4; }
        else if (e < CP_E) { const bool isv = e >= CP_D; e -= isv ? CP_D : CP_C; const int c = (e & 31) * 4, rr = (e >> 5) & 127, db = e >> 12;
            if (rr < WIN - TS) v = *(const f32x4*)(P.in[isv ? I_CV : I_CK] + ((size_t)db * WIN + rr + TS) * 128 + c);
            else v = ld_bf4(U + (size_t)(NTOK_P + db * TS + rr - (WIN - TS)) * INW + (isv ? C_V : C_K) + c);
            dst = out + (isv ? O_VWS : O_KWS) + (size_t)e * 4; }
        else { e -= CP_E; const int c = (e & 127) * 4, q = e >> 7, rr = q % PST, db = q / PST;
            if (rr < PST - TS) v = *(const f32x4*)(P.in[I_SP] + ((size_t)db * PST + rr + TS) * PW + c);
            else v = ld_bf4(U + (size_t)(NTOK_P + db * TS + rr - (PST - TS)) * INW + C_UP + c);
            dst = out + O_PSS + (size_t)e * 4; }
        *(f32x4*)dst = v;
    }
}
__device__ __forceinline__ void p5_norm(const Params& P, int vcu, int G, int wave, int lane) {
    const float* T = (const float*)(P.ws + WS_T); bf16_t* HN = (bf16_t*)(P.ws + WS_BUF0);
    const int gw = vcu * NWAVES + wave, NGW = G * NWAVES;
    f32x4 g1[4], g2[4];
#pragma unroll
    for (int j = 0; j < 4; ++j) { g1[j] = *(const f32x4*)(P.in[I_G1] + 4 * lane + 256 * j); g2[j] = *(const f32x4*)(P.in[I_G2] + 4 * lane + 256 * j); }
    for (int m = gw; m < M; m += NGW) {
        const f32x4* tr = (const f32x4*)(T + (size_t)m * D) + lane; const f32x4* xr = (const f32x4*)xrow(P, m) + lane;
        f32x4 tv[4], xv[4]; float s = 0.f;
#pragma unroll
        for (int j = 0; j < 4; ++j) { tv[j] = tr[64 * j]; xv[j] = xr[64 * j]; s += (tv[j].x * tv[j].x + tv[j].y * tv[j].y) + (tv[j].z * tv[j].z + tv[j].w * tv[j].w); }
        const float r1 = 1.0f / sqrtf(wave_sum(s) * (1.f / D) + RMS_EPS); float s2 = 0.f;
#pragma unroll
        for (int j = 0; j < 4; ++j) { xv[j] = xv[j] + tv[j] * r1 * g1[j]; s2 += (xv[j].x * xv[j].x + xv[j].y * xv[j].y) + (xv[j].z * xv[j].z + xv[j].w * xv[j].w); }
        const float r2 = 1.0f / sqrtf(wave_sum(s2) * (1.f / D) + RMS_EPS);
        f32x4* ho = (f32x4*)(P.out + O_Y + (size_t)m * D) + lane; u32x2* o8 = (u32x2*)(HN + (size_t)m * D) + lane;
#pragma unroll
        for (int j = 0; j < 4; ++j) { ho[64 * j] = xv[j]; const f32x4 n = xv[j] * r2 * g2[j]; u32x2 w; w.x = cvtpk(n.x, n.y); w.y = cvtpk(n.z, n.w); o8[64 * j] = w; }
    }
}
__device__ __forceinline__ void p8_norm(const Params& P, int vcu, int G, int wave, int lane) {
    const float* T = (const float*)(P.ws + WS_T2);
    const int gw = vcu * NWAVES + wave, NGW = G * NWAVES;
    f32x4 g3[4];
#pragma unroll
    for (int j = 0; j < 4; ++j) g3[j] = *(const f32x4*)(P.in[I_G3] + 4 * lane + 256 * j);
    for (int m = gw; m < M; m += NGW) {
        const f32x4* tr = (const f32x4*)(T + (size_t)m * D) + lane; f32x4* ho = (f32x4*)(P.out + O_Y + (size_t)m * D) + lane;
        f32x4 tv[4], hv[4]; float s = 0.f;
#pragma unroll
        for (int j = 0; j < 4; ++j) { tv[j] = tr[64 * j]; hv[j] = ho[64 * j]; s += (tv[j].x * tv[j].x + tv[j].y * tv[j].y) + (tv[j].z * tv[j].z + tv[j].w * tv[j].w); }
        const float r3 = 1.0f / sqrtf(wave_sum(s) * (1.f / D) + RMS_EPS);
#pragma unroll
        for (int j = 0; j < 4; ++j) ho[64 * j] = hv[j] + tv[j] * r3 * g3[j];
    }
}

constexpr int NPHASE = 9;
__global__ void __launch_bounds__(NTHR, 2) fwd_kernel(Params P) {
    extern __shared__ __attribute__((aligned(16))) unsigned char lds_raw[];
    LAS unsigned char* lds = (LAS unsigned char*)lds_raw;
    const int tid = threadIdx.x, lane = tid & 63, wave = __builtin_amdgcn_readfirstlane(tid >> 6);
    const int G = gridDim.x, bx = blockIdx.x, vcu = (G % 8 == 0) ? (bx % 8) * (G / 8) + bx / 8 : bx;
    unsigned char* ws = P.ws;
    const int lo = P.ph_lo, hi = P.ph_hi;
#ifndef PH_MASK
#define PH_MASK 0x1ff
#endif
#define IN(k) (((PH_MASK >> (k)) & 1) && lo <= (k) && (k) < hi)
#if MK_ONE_LAUNCH
#define SEAM(k) do { if (IN(k) && IN((k) + 1)) { cg::this_grid().sync(); } } while (0)
#else
#define SEAM(k) do { } while (0)
#endif
    if (IN(0)) { p0_prologue(P, lds, vcu, G, wave, lane); __syncthreads(); }
    SEAM(0);
    if (IN(1)) {
        pg8::Gemm g{(const bf16_t*)(ws + WS_BUF0), (const bf16_t*)(ws + WS_WIN), M, INW, D}; pg8::StaticOrder S; S.init(M, INW, G, bx);
        pg8::EpiIn E{(bf16_t*)(ws + WS_U), P.in[I_BIN]};
        pg8::gemm_phase<pg8::EpiIn, pg8::StaticOrder, true>(lds, g, S, E);
    }
    SEAM(1);
    if (IN(2)) {
        load_bt(P, lds);
        constexpr int NA = 512, NC = M / 64, NS = 256, NTOT = NA + NC + NS + CP_NCHUNK;
        for (int u = bx; u < NTOT; u += G) {
            int lane_o = lane, tx_o = tid; asm volatile("" : "+v"(lane_o), "+v"(tx_o));
#ifndef P2_MASK
#define P2_MASK 15
#endif
            if (u < NA) { if (P2_MASK & 1) attn_unit(P, lds, true, u, wave, lane_o, tx_o); }
            else if (u < NA + NC) { if (P2_MASK & 2) pool_unit(P, u - NA, wave, lane_o); }
            else if (u < NA + NC + NS) { if (P2_MASK & 4) attn_unit(P, lds, false, u - NA - NC, wave, lane_o, tx_o); }
            else { if (P2_MASK & 8) copy_chunk(P, u - NA - NC - NS, tx_o); }
        }
        __syncthreads();
    }
    SEAM(2);
    if (IN(3)) {
        pg8::Gemm g{(const bf16_t*)(ws + WS_OZ), (const bf16_t*)(ws + WS_WAP), M, D, D}; pg8::Order4 S{(M / 256) * 4, G, vcu};
        pg8::EpiGate E{(const bf16_t*)(ws + WS_U), (bf16_t*)(ws + WS_BUF2)};
        pg8::gemm_phase<pg8::EpiGate, pg8::Order4, true>(lds, g, S, E);
    }
    SEAM(3);
    if (IN(4)) {
        pg8::Gemm g{(const bf16_t*)(ws + WS_BUF2), (const bf16_t*)(ws + WS_WOUT), M, D, D}; pg8::Order4 S{(M / 256) * 4, G, vcu};
        pg8::EpiF32 E{(float*)(ws + WS_T), D};
        pg8::gemm_phase<pg8::EpiF32, pg8::Order4, true>(lds, g, S, E);
    }
    SEAM(4);
    if (IN(5)) p5_norm(P, vcu, G, wave, lane);
    SEAM(5);
    if (IN(6)) {
        pg8::Gemm g{(const bf16_t*)(ws + WS_BUF0), (const bf16_t*)(ws + WS_WUP), M, FF, D}; pg8::StaticOrder S; S.init(M, FF, G, bx);
        pg8::EpiRelu2 E{(bf16_t*)(ws + WS_HID)};
        pg8::gemm_phase<pg8::EpiRelu2, pg8::StaticOrder, true>(lds, g, S, E);
    }
    SEAM(6);
    if (IN(7)) {
        pg8::Gemm g{(const bf16_t*)(ws + WS_HID), (const bf16_t*)(ws + WS_WDN), M, D, FF}; pg8::Order4 S{(M / 256) * 4, G, vcu};
        pg8::EpiF32 E{(float*)(ws + WS_T2), D};
        pg8::gemm_phase<pg8::EpiF32, pg8::Order4, true>(lds, g, S, E);
    }
    SEAM(7);
    if (IN(8)) p8_norm(P, vcu, G, wave, lane);
#undef IN
#undef SEAM
}


#ifdef DBG_STOP
__global__ void dbg_dump(Params P, size_t off, int ld, int c0, int isf32) {
    const size_t n = (size_t)M * D;
    for (size_t i = (size_t)blockIdx.x * blockDim.x + threadIdx.x; i < n; i += (size_t)gridDim.x * blockDim.x) {
        const size_t m = i / D, c = i % D;
        float v = isf32 ? ((const float*)(P.ws + off))[m * ld + c0 + c] : bf2f(((const bf16_t*)(P.ws + off))[m * ld + c0 + c]);
        P.out[i] = v;
    }
}
#endif
extern "C" void kernel_launch(void* const* d_in, const int* in_sizes, int n_in, void* d_out, int out_size, void* d_ws, size_t ws_size, hipStream_t stream) {
    static int grid = 0;
    if (grid == 0) {
        if (n_in != 20 || in_sizes[0] != NTOK_P * D || (size_t)out_size != O_END || ws_size < WS_END) {
            fprintf(stderr, "kernel_launch: shape mismatch: n_in %d in0 %d out %d (want %zu) ws %zu (want %zu)\n", n_in, n_in > 0 ? in_sizes[0] : -1, out_size, (size_t)O_END, ws_size, (size_t)WS_END); grid = -1; return; }
        int dev = 0, cus = 0, per_cu = 0;
        if (hipGetDevice(&dev) != hipSuccess || hipDeviceGetAttribute(&cus, hipDeviceAttributeMultiprocessorCount, dev) != hipSuccess) { grid = -1; return; }
        if (hipFuncSetAttribute((const void*)fwd_kernel, hipFuncAttributeMaxDynamicSharedMemorySize, LDS_BYTES) != hipSuccess) { fprintf(stderr, "kernel_launch: hipFuncSetAttribute failed\n"); grid = -1; return; }
        if (hipOccupancyMaxActiveBlocksPerMultiprocessor(&per_cu, (const void*)fwd_kernel, NTHR, LDS_BYTES) != hipSuccess || per_cu < 1) { fprintf(stderr, "kernel_launch: occupancy query says %d\n", per_cu); per_cu = 1; }
        (void)hipGetLastError();
        grid = cus;
    }
    if (grid < 0) return;
    Params p{};
    for (int i = 0; i < 20; ++i) p.in[i] = (const float*)d_in[i];
    p.out = (float*)d_out; p.ws = (unsigned char*)d_ws;
#if MK_ONE_LAUNCH
    p.ph_lo = 0; p.ph_hi = NPHASE;
    void* args[] = {&p};
    hipError_t e = hipLaunchCooperativeKernel((const void*)fwd_kernel, dim3(grid), dim3(NTHR), args, LDS_BYTES, stream);
    if (e != hipSuccess) fprintf(stderr, "cooperative launch failed: %s (grid %d)\n", hipGetErrorString(e), grid);
#else
#ifdef DBG_STOP
    for (int ph = 0; ph <= DBG_STOP; ++ph) { p.ph_lo = ph; p.ph_hi = ph + 1; hipLaunchKernelGGL(fwd_kernel, dim3(grid), dim3(NTHR), LDS_BYTES, stream, p); }
    hipLaunchKernelGGL(dbg_dump, dim3(2048), dim3(256), 0, stream, p, (size_t)DBG_OFF, DBG_LD, DBG_C0, DBG_F32);
#else
    for (int ph = 0; ph < NPHASE; ++ph) { p.ph_lo = ph; p.ph_hi = ph + 1; hipLaunchKernelGGL(fwd_kernel, dim3(grid), dim3(NTHR), LDS_BYTES, stream, p); }
#endif
#endif
}
```
